# Optimizing an MI355X kernel written in HIP

```python
import math
import jax, jax.numpy as jnp
from jax import lax
import numpy as np

D_MODEL = 1024
BATCH = 8
SEQ = 2048
DEPTH = 1

HEAD_DIM = 64
ATTN_HEADS = 8
DILATION_GROUPS = ((128, 1), (512, 4), (2048, 16))
N_GROUPS = len(DILATION_GROUPS)
ATTN_WIDTH = ATTN_HEADS * HEAD_DIM
QKV_WIDTH = N_GROUPS * ATTN_WIDTH
BLOCK = 128
ROPE_THETA = 10000.0
NEG_INF = -1e30
SSM_GROUP = 16
SSM_GROUPS = 32
SSM_WIDTH = SSM_GROUP * SSM_GROUPS
SSM_STATE = 64
DT_MIN = 1e-3
DT_MAX = 1e-1
N_BRANCH = 2
IN_WIDTH = 3 * QKV_WIDTH + SSM_WIDTH + N_BRANCH * D_MODEL
D_FF = -(-(8 * D_MODEL) // (3 * 256)) * 256
DN_ALPHA = (2.0 * DEPTH) ** 0.25
DN_BETA = (8.0 * DEPTH) ** -0.25
LN_EPS = 1e-5

kernel_name = "dilated_attn_s5_gated_hybrid_deepnorm"


def layer_norm(x, g, b):
    xf = x.astype(jnp.float32)
    mu = jnp.mean(xf, axis=-1, keepdims=True)
    var = jnp.mean(jnp.square(xf - mu), axis=-1, keepdims=True)
    y = (xf - mu) * lax.rsqrt(var + LN_EPS)
    return (y * g.astype(jnp.float32) + b.astype(jnp.float32)).astype(x.dtype)


def apply_rope(t, pos):
    half = HEAD_DIM // 2
    inv_freq = ROPE_THETA ** (-jnp.arange(half, dtype=jnp.float32) / half)
    ang = pos[:, None] * inv_freq[None, :]
    cos = jnp.cos(ang)[None, :, None, None, :]
    sin = jnp.sin(ang)[None, :, None, None, :]
    t1 = t[..., :half].astype(jnp.float32)
    t2 = t[..., half:].astype(jnp.float32)
    return jnp.concatenate([t1 * cos - t2 * sin, t1 * sin + t2 * cos], axis=-1)


def dilated_group_attention(q, k, v, window, dilation):
    b, s, h, dh = q.shape
    n = s // dilation
    nb = -(-n // BLOCK)
    n_pad = nb * BLOCK
    back = window // dilation

    def to_phase_blocks(t):
        t = t.reshape(b, n, dilation, h, dh)
        t = jnp.pad(t, ((0, 0), (0, n_pad - n), (0, 0), (0, 0), (0, 0)))
        return t.reshape(b, nb, BLOCK, dilation, h, dh)

    def with_prev_block(t):
        prev = jnp.pad(t, ((0, 0), (1, 0), (0, 0), (0, 0), (0, 0), (0, 0)))[:, :-1]
        return jnp.concatenate([prev, t], axis=2)

    qb = to_phase_blocks(q)
    kw = with_prev_block(to_phase_blocks(k))
    vw = with_prev_block(to_phase_blocks(v))

    scores = jnp.einsum("bnqrhd,bnkrhd->bnrhqk", qb, kw,
                        preferred_element_type=jnp.float32) / math.sqrt(dh)
    a_idx = jnp.arange(BLOCK)[None, :, None]
    c_idx = jnp.arange(2 * BLOCK)[None, None, :]
    blk = jnp.arange(nb)[:, None, None]
    dist = BLOCK + a_idx - c_idx
    key_sub = (blk - 1) * BLOCK + c_idx
    valid = (dist >= 0) & (dist <= back) & (key_sub >= 0)
    scores = jnp.where(valid[None, :, None, None], scores, NEG_INF)
    lse = jax.nn.logsumexp(scores, axis=-1)
    probs = jnp.exp(scores - lse[..., None])
    out = jnp.einsum("bnrhqk,bnkrhd->bnqrhd", probs, vw.astype(jnp.float32))
    out = out.reshape(b, n_pad, dilation, h, dh)[:, :n].reshape(b, s, h, dh)
    lse = jnp.transpose(lse, (0, 1, 4, 2, 3)).reshape(b, n_pad, dilation, h)[:, :n]
    return out, lse.reshape(b, s, h)


def s5_ssm(u, a_re, a_im, log_dt, b_re, b_im, c_re, c_im, d_skip):
    f32 = jnp.float32
    bsz, s, _ = u.shape
    ug = u.astype(f32).reshape(bsz, s, SSM_GROUPS, SSM_GROUP)
    lam = lax.complex(a_re.astype(f32), a_im.astype(f32))
    dt = jnp.exp(log_dt.astype(f32))[:, None]
    a_bar = jnp.exp(lam * dt)
    b_c = lax.complex(b_re.astype(f32), b_im.astype(f32))
    b_bar = ((a_bar - 1.0) / lam)[..., None] * b_c
    bu = jnp.einsum("gph,bsgh->bsgp", b_bar, ug.astype(jnp.complex64))
    a_seq = jnp.broadcast_to(a_bar, bu.shape)

    def combine(left, right):
        a_l, x_l = left
        a_r, x_r = right
        return a_r * a_l, a_r * x_l + x_r

    _, states = lax.associative_scan(combine, (a_seq, bu), axis=1)
    c_c = lax.complex(c_re.astype(f32), c_im.astype(f32))
    y = jnp.einsum("ghp,bsgp->bsgh", c_c, states).real
    y = y + d_skip.astype(f32).reshape(SSM_GROUPS, SSM_GROUP) * ug
    return y.reshape(bsz, s, SSM_WIDTH)


def setup_inputs(seed: int = 0) -> dict:
    key = jax.random.key(seed)
    ks = jax.random.split(key, 24)
    f32 = jnp.float32
    L = DEPTH

    def nrm(k, shape, scale):
        return jax.random.normal(k, shape, f32) * scale

    x = jax.random.normal(ks[0], (BATCH, SEQ, D_MODEL), f32)
    w_in = nrm(ks[1], (L, D_MODEL, IN_WIDTH), D_MODEL ** -0.5)
    b_gate = nrm(ks[2], (L, N_BRANCH, D_MODEL), 0.02)
    w_attn_br = nrm(ks[3], (L, ATTN_WIDTH, D_MODEL), ATTN_WIDTH ** -0.5)
    w_ssm_br = nrm(ks[4], (L, SSM_WIDTH, D_MODEL), SSM_WIDTH ** -0.5)
    w_out = nrm(ks[5], (L, D_MODEL, D_MODEL), DN_BETA * D_MODEL ** -0.5)
    ssm_a_re = -0.5 + nrm(ks[6], (L, SSM_GROUPS, SSM_STATE), 0.01)
    ssm_a_im = (math.pi * jnp.arange(SSM_STATE, dtype=f32))[None, None, :] + nrm(ks[7], (L, SSM_GROUPS, SSM_STATE), 0.01)
    ssm_log_dt = jax.random.uniform(ks[8], (L, SSM_GROUPS), f32, math.log(DT_MIN), math.log(DT_MAX))
    ssm_b_re = nrm(ks[9], (L, SSM_GROUPS, SSM_STATE, SSM_GROUP), (2 * SSM_GROUP) ** -0.5)
    ssm_b_im = nrm(ks[10], (L, SSM_GROUPS, SSM_STATE, SSM_GROUP), (2 * SSM_GROUP) ** -0.5)
    ssm_c_re = nrm(ks[11], (L, SSM_GROUPS, SSM_GROUP, SSM_STATE), SSM_STATE ** -0.5)
    ssm_c_im = nrm(ks[12], (L, SSM_GROUPS, SSM_GROUP, SSM_STATE), SSM_STATE ** -0.5)
    ssm_d = nrm(ks[13], (L, SSM_WIDTH), 1.0)
    w_glu = nrm(ks[14], (L, SSM_WIDTH, 2 * SSM_WIDTH), SSM_WIDTH ** -0.5)
    ln1_g = 1.0 + nrm(ks[15], (L, D_MODEL), 0.02)
    ln1_b = nrm(ks[16], (L, D_MODEL), 0.02)
    w_ff_gate = nrm(ks[17], (L, D_MODEL, D_FF), D_MODEL ** -0.5)
    w_ff_up = nrm(ks[18], (L, D_MODEL, D_FF), D_MODEL ** -0.5)
    w_ff_down = nrm(ks[19], (L, D_FF, D_MODEL), DN_BETA * D_FF ** -0.5)
    ln2_g = 1.0 + nrm(ks[20], (L, D_MODEL), 0.02)
    ln2_b = nrm(ks[21], (L, D_MODEL), 0.02)
    return {"x": x, "w_in": w_in, "b_gate": b_gate, "w_attn_br": w_attn_br,
            "w_ssm_br": w_ssm_br, "w_out": w_out, "ssm_a_re": ssm_a_re,
            "ssm_a_im": ssm_a_im, "ssm_log_dt": ssm_log_dt, "ssm_b_re": ssm_b_re,
            "ssm_b_im": ssm_b_im, "ssm_c_re": ssm_c_re, "ssm_c_im": ssm_c_im,
            "ssm_d": ssm_d, "w_glu": w_glu, "ln1_g": ln1_g, "ln1_b": ln1_b,
            "w_ff_gate": w_ff_gate, "w_ff_up": w_ff_up, "w_ff_down": w_ff_down,
            "ln2_g": ln2_g, "ln2_b": ln2_b}


def reference(x, w_in, b_gate, w_attn_br, w_ssm_br, w_out, ssm_a_re, ssm_a_im,
              ssm_log_dt, ssm_b_re, ssm_b_im, ssm_c_re, ssm_c_im, ssm_d, w_glu,
              ln1_g, ln1_b, w_ff_gate, w_ff_up, w_ff_down, ln2_g, ln2_b):
    bsz, s, _ = x.shape
    pos = jnp.arange(s, dtype=jnp.float32)
    for layer in range(DEPTH):
        proj = x @ w_in[layer]
        q = proj[..., :QKV_WIDTH].reshape(bsz, s, N_GROUPS, ATTN_HEADS, HEAD_DIM)
        k = proj[..., QKV_WIDTH:2 * QKV_WIDTH].reshape(bsz, s, N_GROUPS, ATTN_HEADS, HEAD_DIM)
        v = proj[..., 2 * QKV_WIDTH:3 * QKV_WIDTH].reshape(bsz, s, N_GROUPS, ATTN_HEADS, HEAD_DIM)
        u = proj[..., 3 * QKV_WIDTH:3 * QKV_WIDTH + SSM_WIDTH]
        gate_logits = proj[..., 3 * QKV_WIDTH + SSM_WIDTH:].reshape(bsz, s, N_BRANCH, D_MODEL)
        q = apply_rope(q, pos)
        k = apply_rope(k, pos)

        outs, lses = [], []
        for g, (window, dilation) in enumerate(DILATION_GROUPS):
            o_g, lse_g = dilated_group_attention(q[:, :, g], k[:, :, g], v[:, :, g], window, dilation)
            outs.append(o_g)
            lses.append(lse_g)
        wts = jax.nn.softmax(jnp.stack(lses, axis=0), axis=0)
        attn = jnp.sum(wts[..., None] * jnp.stack(outs, axis=0), axis=0)
        y_attn = attn.reshape(bsz, s, ATTN_WIDTH).astype(x.dtype) @ w_attn_br[layer]

        y_s = s5_ssm(u, ssm_a_re[layer], ssm_a_im[layer], ssm_log_dt[layer], ssm_b_re[layer],
                     ssm_b_im[layer], ssm_c_re[layer], ssm_c_im[layer], ssm_d[layer])
        glu = jax.nn.gelu(y_s).astype(x.dtype) @ w_glu[layer]
        y_s = glu[..., :SSM_WIDTH] * jax.nn.sigmoid(glu[..., SSM_WIDTH:])
        y_ssm = y_s @ w_ssm_br[layer]

        gates = jax.nn.sigmoid((gate_logits + b_gate[layer]).astype(jnp.float32))
        mixed = gates[..., 0, :] * y_attn.astype(jnp.float32) + gates[..., 1, :] * y_ssm.astype(jnp.float32)
        mix_out = mixed.astype(x.dtype) @ w_out[layer]
        h = layer_norm(DN_ALPHA * x + mix_out.astype(x.dtype), ln1_g[layer], ln1_b[layer])

        ff = (jax.nn.silu(h @ w_ff_gate[layer]) * (h @ w_ff_up[layer])) @ w_ff_down[layer]
        x = layer_norm(DN_ALPHA * h + ff.astype(h.dtype), ln2_g[layer], ln2_b[layer])
    return x
```

```cpp
#include <hip/hip_runtime.h>
#include <cstdint>
#include <cstdio>

namespace nv {
constexpr int S = 2048, D = 1024, NBATCH = 8, INW = 7168, AW = 512, SW = 512, DFF = 2816;
constexpr float DN_ALPHA = 1.189207115002721f;
constexpr float LN_EPS = 1e-5f;

__device__ __forceinline__ void sincos_d(double ang, double& s, double& c) {
    const double TWO_PI_HI = 6.283185307179586232, TWO_PI_LO = 2.4492935982947064e-16;
    const double k = rint(ang * 0.15915494309189534561);
    double r = ang - k * TWO_PI_HI; r -= k * TWO_PI_LO;
    const double r2 = r * r;
    double ss = 1.0, cs = 1.0;
#pragma unroll
    for (int n = 13; n >= 1; --n) ss = 1.0 - ss * r2 / (double)((2 * n) * (2 * n + 1));
#pragma unroll
    for (int n = 13; n >= 1; --n) cs = 1.0 - cs * r2 / (double)((2 * n - 1) * (2 * n));
    s = r * ss; c = cs;
}

__global__ void __launch_bounds__(256) gemm_nn(const float* __restrict__ A, int lda, const float* __restrict__ B, int ldb, float* __restrict__ C, int ldc, int K) {
    __shared__ float As[16][65];
    __shared__ float Bs[16][64];
    const int tx = threadIdx.x & 15, ty = threadIdx.x >> 4;
    const int m0 = blockIdx.y * 64, n0 = blockIdx.x * 64;
    float acc[4][4];
#pragma unroll
    for (int i = 0; i < 4; ++i)
#pragma unroll
        for (int j = 0; j < 4; ++j) acc[i][j] = 0.f;
    for (int k0 = 0; k0 < K; k0 += 16) {
#pragma unroll
        for (int i = 0; i < 4; ++i) { const int e = threadIdx.x + i * 256; const int m = e >> 4, k = e & 15; As[k][m] = A[(size_t)(m0 + m) * lda + k0 + k]; }
#pragma unroll
        for (int i = 0; i < 4; ++i) { const int e = threadIdx.x + i * 256; const int k = e >> 6, n = e & 63; Bs[k][n] = B[(size_t)(k0 + k) * ldb + n0 + n]; }
        __syncthreads();
#pragma unroll
        for (int k = 0; k < 16; ++k) {
            float a[4], b[4];
#pragma unroll
            for (int i = 0; i < 4; ++i) { a[i] = As[k][ty * 4 + i]; b[i] = Bs[k][tx * 4 + i]; }
#pragma unroll
            for (int i = 0; i < 4; ++i)
#pragma unroll
                for (int j = 0; j < 4; ++j) acc[i][j] += a[i] * b[j];
        }
        __syncthreads();
    }
#pragma unroll
    for (int i = 0; i < 4; ++i)
#pragma unroll
        for (int j = 0; j < 4; ++j) C[(size_t)(m0 + ty * 4 + i) * ldc + n0 + tx * 4 + j] = acc[i][j];
}

__global__ void rope_k(float* proj) {
    const int idx = blockIdx.x * blockDim.x + threadIdx.x;
    if (idx >= S * 48 * 32) return;
    const int i = idx & 31, hd = (idx >> 5) % 48, t = idx / (32 * 48);
    const double inv_freq = exp2(-(double)i / 32.0 * 13.287712379549449);
    double s, c; sincos_d((double)t * inv_freq, s, c);
    float* p = proj + (size_t)t * INW + hd * 64 + i;
    const float t1 = p[0], t2 = p[32];
    p[0] = t1 * (float)c - t2 * (float)s;
    p[32] = t1 * (float)s + t2 * (float)c;
}

__global__ void __launch_bounds__(64) attn_k(const float* __restrict__ proj, float* __restrict__ attn) {
    const int idx = blockIdx.x * blockDim.x + threadIdx.x;
    const int h = idx & 7, t = idx >> 3;
    if (t >= S) return;
    float m = -1e30f, l = 0.f, acc[64];
#pragma unroll
    for (int d = 0; d < 64; ++d) acc[d] = 0.f;
    for (int g = 0; g < 3; ++g) {
        const int dil = (g == 0) ? 1 : (g == 1 ? 4 : 16);
        float q[64];
        const float* qp = proj + (size_t)t * INW + g * 512 + h * 64;
#pragma unroll
        for (int d = 0; d < 64; ++d) q[d] = qp[d];
        for (int j = 0; j <= 128; ++j) {
            const int kt = t - j * dil;
            if (kt < 0) break;
            const float* kp = proj + (size_t)kt * INW + 1536 + g * 512 + h * 64;
            const float* vp = proj + (size_t)kt * INW + 3072 + g * 512 + h * 64;
            float s = 0.f;
#pragma unroll
            for (int d = 0; d < 64; ++d) s += q[d] * kp[d];
            s *= 0.125f;
            const float mn = fmaxf(m, s);
            const float f = __expf(m - mn), p = __expf(s - mn);
            l = l * f + p;
#pragma unroll
            for (int d = 0; d < 64; ++d) acc[d] = acc[d] * f + p * vp[d];
            m = mn;
        }
    }
    const float inv = 1.f / l;
    float* op = attn + (size_t)t * AW + h * 64;
#pragma unroll
    for (int d = 0; d < 64; ++d) op[d] = acc[d] * inv;
}

__global__ void ssm_params_k(const float* a_re, const float* a_im, const float* log_dt, const float* b_re, const float* b_im, float2* abar, float2* bbar) {
    const int idx = blockIdx.x * blockDim.x + threadIdx.x;
    if (idx >= 32 * 64) return;
    const int g = idx >> 6;
    const double dt = exp((double)log_dt[g]);
    const double lr = a_re[idx], li = a_im[idx];
    double s, c; sincos_d(li * dt, s, c);
    const double mag = exp(lr * dt);
    const double ar = mag * c, ai = mag * s;
    abar[idx] = make_float2((float)ar, (float)ai);
    const double nr = ar - 1.0, ni = ai, den = lr * lr + li * li;
    const double fr = (nr * lr + ni * li) / den, fi = (ni * lr - nr * li) / den;
    for (int h = 0; h < 16; ++h) {
        const double br = b_re[idx * 16 + h], bi = b_im[idx * 16 + h];
        bbar[idx * 16 + h] = make_float2((float)(fr * br - fi * bi), (float)(fr * bi + fi * br));
    }
}
__global__ void ssm_bu_k(const float* __restrict__ proj, const float2* __restrict__ bbar, float2* __restrict__ bu) {
    const int idx = blockIdx.x * blockDim.x + threadIdx.x;
    if (idx >= S * 2048) return;
    const int gp = idx & 2047, t = idx >> 11, g = gp >> 6;
    const float* u = proj + (size_t)t * INW + 4608 + g * 16;
    float re = 0.f, im = 0.f;
#pragma unroll
    for (int h = 0; h < 16; ++h) { const float2 b = bbar[gp * 16 + h]; const float uu = u[h]; re += b.x * uu; im += b.y * uu; }
    bu[idx] = make_float2(re, im);
}
__global__ void ssm_scan_k(const float2* __restrict__ abar, float2* st) {
    const int gp = blockIdx.x * blockDim.x + threadIdx.x;
    if (gp >= 2048) return;
    const float2 a = abar[gp];
    float hr = 0.f, hi = 0.f;
    for (int t = 0; t < S; ++t) {
        const float2 b = st[(size_t)t * 2048 + gp];
        const float nr = a.x * hr - a.y * hi + b.x, ni = a.x * hi + a.y * hr + b.y;
        hr = nr; hi = ni;
        st[(size_t)t * 2048 + gp] = make_float2(hr, hi);
    }
}
__global__ void ssm_y_k(const float* __restrict__ proj, const float2* __restrict__ st, const float* __restrict__ c_re, const float* __restrict__ c_im, const float* __restrict__ dsk, float* __restrict__ gy) {
    const int idx = blockIdx.x * blockDim.x + threadIdx.x;
    if (idx >= S * SW) return;
    const int c = idx & 511, t = idx >> 9, g = c >> 4;
    const float2* sp = st + (size_t)t * 2048 + g * 64;
    float y = 0.f;
    for (int p = 0; p < 64; ++p) { const float2 s = sp[p]; y += c_re[c * 64 + p] * s.x - c_im[c * 64 + p] * s.y; }
    y += dsk[c] * proj[(size_t)t * INW + 4608 + c];
    const float u = 0.7978845608028654f * (y + 0.044715f * y * y * y);
    gy[idx] = 0.5f * y * (1.f + tanhf(u));
}
__device__ __forceinline__ float sigmoidf_(float x) { return 1.f / (1.f + __expf(-x)); }
__global__ void glu_act_k(const float* __restrict__ glu, float* __restrict__ ys2) {
    const int idx = blockIdx.x * blockDim.x + threadIdx.x;
    if (idx >= S * SW) return;
    const int c = idx & 511, t = idx >> 9;
    ys2[idx] = glu[(size_t)t * 1024 + c] * sigmoidf_(glu[(size_t)t * 1024 + 512 + c]);
}
__global__ void mix_k(const float* __restrict__ proj, const float* __restrict__ bg, const float* __restrict__ ya, const float* __restrict__ ys, float* __restrict__ mixed) {
    const int idx = blockIdx.x * blockDim.x + threadIdx.x;
    if (idx >= S * D) return;
    const int c = idx & 1023, t = idx >> 10;
    const float g0 = sigmoidf_(proj[(size_t)t * INW + 5120 + c] + bg[c]);
    const float g1 = sigmoidf_(proj[(size_t)t * INW + 6144 + c] + bg[1024 + c]);
    mixed[idx] = g0 * ya[idx] + g1 * ys[idx];
}
__global__ void swiglu_k(float* __restrict__ gate, const float* __restrict__ up) {
    const int idx = blockIdx.x * blockDim.x + threadIdx.x;
    if (idx >= S * DFF) return;
    const float g = gate[idx];
    gate[idx] = g * sigmoidf_(g) * up[idx];
}
__global__ void __launch_bounds__(256) ln_k(const float* __restrict__ a, const float* __restrict__ b, const float* __restrict__ g, const float* __restrict__ be, float* __restrict__ out) {
    __shared__ float red[8];
    const int t = blockIdx.x, tid = threadIdx.x;
    float v[4]; float s = 0.f;
#pragma unroll
    for (int i = 0; i < 4; ++i) { const int c = tid + i * 256; v[i] = DN_ALPHA * a[(size_t)t * D + c] + b[(size_t)t * D + c]; s += v[i]; }
#pragma unroll
    for (int o = 32; o >= 1; o >>= 1) s += __shfl_xor(s, o);
    if ((tid & 63) == 0) red[tid >> 6] = s;
    __syncthreads();
    const float mean = (red[0] + red[1] + red[2] + red[3]) * (1.f / D);
    float q = 0.f;
#pragma unroll
    for (int i = 0; i < 4; ++i) { v[i] -= mean; q += v[i] * v[i]; }
#pragma unroll
    for (int o = 32; o >= 1; o >>= 1) q += __shfl_xor(q, o);
    if ((tid & 63) == 0) red[4 + (tid >> 6)] = q;
    __syncthreads();
    const float rstd = 1.f / sqrtf((red[4] + red[5] + red[6] + red[7]) * (1.f / D) + LN_EPS);
#pragma unroll
    for (int i = 0; i < 4; ++i) { const int c = tid + i * 256; out[(size_t)t * D + c] = v[i] * rstd * g[c] + be[c]; }
}
}

extern "C" void kernel_launch(void* const* d_in, const int* in_sizes, int n_in, void* d_out, int out_size, void* d_ws, size_t ws_size, hipStream_t stream) {
    using namespace nv;
    const float* x = (const float*)d_in[0]; const float* w_in = (const float*)d_in[1]; const float* b_gate = (const float*)d_in[2];
    const float* w_attn_br = (const float*)d_in[3]; const float* w_ssm_br = (const float*)d_in[4]; const float* w_out = (const float*)d_in[5];
    const float* a_re = (const float*)d_in[6]; const float* a_im = (const float*)d_in[7]; const float* log_dt = (const float*)d_in[8];
    const float* b_re = (const float*)d_in[9]; const float* b_im = (const float*)d_in[10]; const float* c_re = (const float*)d_in[11]; const float* c_im = (const float*)d_in[12];
    const float* ssm_d = (const float*)d_in[13]; const float* w_glu = (const float*)d_in[14]; const float* ln1_g = (const float*)d_in[15]; const float* ln1_b = (const float*)d_in[16];
    const float* w_ff_gate = (const float*)d_in[17]; const float* w_ff_up = (const float*)d_in[18]; const float* w_ff_down = (const float*)d_in[19];
    const float* ln2_g = (const float*)d_in[20]; const float* ln2_b = (const float*)d_in[21];
    float* out = (float*)d_out;
    char* ws = (char*)d_ws;
    const size_t MiB = 1u << 20;
    float* proj = (float*)(ws + 0);
    float2* bu = (float2*)(ws + 56 * MiB);
    float* attn = (float*)(ws + 88 * MiB);
    float* gy = (float*)(ws + 92 * MiB);
    float* glu = (float*)(ws + 96 * MiB);
    float* ys2 = (float*)(ws + 104 * MiB);
    float* yssm = (float*)(ws + 108 * MiB);
    float* yattn = (float*)(ws + 116 * MiB);
    float* mixed = (float*)(ws + 124 * MiB);
    float* mixout = (float*)(ws + 132 * MiB);
    float* hbuf = (float*)(ws + 140 * MiB);
    float* gate = (float*)(ws + 148 * MiB);
    float* up = (float*)(ws + 170 * MiB);
    float* ff = (float*)(ws + 192 * MiB);
    float2* abar = (float2*)(ws + 200 * MiB);
    float2* bbar = (float2*)(ws + 201 * MiB);
    ssm_params_k<<<8, 256, 0, stream>>>(a_re, a_im, log_dt, b_re, b_im, abar, bbar);
    for (int b = 0; b < NBATCH; ++b) {
        const float* xb = x + (size_t)b * S * D; float* ob = out + (size_t)b * S * D;
        gemm_nn<<<dim3(INW / 64, S / 64), 256, 0, stream>>>(xb, D, w_in, INW, proj, INW, D);
        rope_k<<<S * 48 * 32 / 256, 256, 0, stream>>>(proj);
        attn_k<<<S * 8 / 64, 64, 0, stream>>>(proj, attn);
        ssm_bu_k<<<S * 2048 / 256, 256, 0, stream>>>(proj, bbar, bu);
        ssm_scan_k<<<2048 / 64, 64, 0, stream>>>(abar, bu);
        ssm_y_k<<<S * SW / 256, 256, 0, stream>>>(proj, bu, c_re, c_im, ssm_d, gy);
        gemm_nn<<<dim3(1024 / 64, S / 64), 256, 0, stream>>>(gy, SW, w_glu, 1024, glu, 1024, SW);
        glu_act_k<<<S * SW / 256, 256, 0, stream>>>(glu, ys2);
        gemm_nn<<<dim3(D / 64, S / 64), 256, 0, stream>>>(ys2, SW, w_ssm_br, D, yssm, D, SW);
        gemm_nn<<<dim3(D / 64, S / 64), 256, 0, stream>>>(attn, AW, w_attn_br, D, yattn, D, AW);
        mix_k<<<S * D / 256, 256, 0, stream>>>(proj, b_gate, yattn, yssm, mixed);
        gemm_nn<<<dim3(D / 64, S / 64), 256, 0, stream>>>(mixed, D, w_out, D, mixout, D, D);
        ln_k<<<S, 256, 0, stream>>>(xb, mixout, ln1_g, ln1_b, hbuf);
        gemm_nn<<<dim3(DFF / 64, S / 64), 256, 0, stream>>>(hbuf, D, w_ff_gate, DFF, gate, DFF, D);
        gemm_nn<<<dim3(DFF / 64, S / 64), 256, 0, stream>>>(hbuf, D, w_ff_up, DFF, up, DFF, D);
        swiglu_k<<<S * DFF / 256, 256, 0, stream>>>(gate, up);
        gemm_nn<<<dim3(D / 64, S / 64), 256, 0, stream>>>(gate, DFF, w_ff_down, D, ff, D, DFF);
        ln_k<<<S, 256, 0, stream>>>(hbuf, ff, ln2_g, ln2_b, ob);
    }
}
```
